# Optimizing an MI355X kernel written in HIP

```python
import math
import jax, jax.numpy as jnp
from jax import lax
import numpy as np

D_MODEL = 1024
BATCH = 8
SEQ = 4096
DEPTH = 1
DEC_BATCH = 2
DEC_SEQ = 16384
PAST_LEN = 128

GRID_W = 64
CONV_WIDTH = D_MODEL // 2
CONV_GROUPS = 8
N_HEADS = 8
HEAD_DIM = 64
ATTN_WIDTH = N_HEADS * HEAD_DIM
MIX_WIDTH = CONV_WIDTH + ATTN_WIDTH
WIN_ROWS = 8
WIN_COLS = 16
CONV_K = 3
PROJ_WIDTH = 4 * CONV_WIDTH + 4 * ATTN_WIDTH
DN_ALPHA = (2.0 * DEPTH) ** 0.25
DN_BETA = (8.0 * DEPTH) ** -0.25
NORM_EPS = 1e-5

kernel_name = "hymba_conv_natten_deepnorm_encoder"


def group_rmsnorm(y, gain, n_groups):
    b, l, w = y.shape
    y32 = y.astype(jnp.float32).reshape(b, l, n_groups, w // n_groups)
    y32 = y32 * lax.rsqrt(jnp.mean(y32 * y32, axis=-1, keepdims=True) + NORM_EPS)
    return (y32.reshape(b, l, w) * gain.astype(jnp.float32)).astype(y.dtype)


def layer_norm(x, g, b):
    x32 = x.astype(jnp.float32)
    mu = jnp.mean(x32, axis=-1, keepdims=True)
    var = jnp.mean(jnp.square(x32 - mu), axis=-1, keepdims=True)
    y = (x32 - mu) * lax.rsqrt(var + NORM_EPS) * g.astype(jnp.float32) + b.astype(jnp.float32)
    return y.astype(x.dtype)


def centred_depthwise_conv(u, w):
    up = jnp.pad(u, ((0, 0), (1, 1), (0, 0)))
    return up[:, :-2] * w[0] + up[:, 1:-1] * w[1] + up[:, 2:] * w[2]


def neighbourhood_attention(q, k, v, rpb):
    bsz, seqlen, h, hd = q.shape
    rows = seqlen // GRID_W
    kh = min(WIN_ROWS, rows)
    q = (q * (hd ** -0.5)).reshape(bsz, rows, GRID_W, h, hd)
    k = k.reshape(bsz, rows, GRID_W, h, hd)
    v = v.reshape(bsz, rows, GRID_W, h, hd)
    cols = np.arange(GRID_W)
    col_start = np.clip(cols - WIN_COLS // 2, 0, GRID_W - WIN_COLS)
    col_idx = col_start[:, None] + np.arange(WIN_COLS)[None, :]
    dc_idx = col_idx - cols[:, None] + (WIN_COLS - 1)
    col_bias = rpb[:, :, dc_idx]

    def row_block(r):
        rs = jnp.clip(r - kh // 2, 0, rows - kh)
        q_r = lax.dynamic_index_in_dim(q, r, axis=1, keepdims=False)
        k_band = lax.dynamic_slice_in_dim(k, rs, kh, axis=1)
        v_band = lax.dynamic_slice_in_dim(v, rs, kh, axis=1)
        k_win = k_band[:, :, col_idx]
        v_win = v_band[:, :, col_idx]
        dr_idx = rs + jnp.arange(kh) - r + (WIN_ROWS - 1)
        bias = jnp.take(col_bias, dr_idx, axis=1)
        bias = jnp.transpose(bias, (0, 2, 1, 3)).astype(jnp.float32)
        s = jnp.einsum('bchd,bkcjhd->bhckj', q_r, k_win).astype(jnp.float32) + bias[None]
        p = jax.nn.softmax(s.reshape(bsz, h, GRID_W, kh * WIN_COLS), axis=-1)
        p = p.reshape(bsz, h, GRID_W, kh, WIN_COLS).astype(v.dtype)
        return jnp.einsum('bhckj,bkcjhd->bchd', p, v_win)

    out = lax.map(row_block, jnp.arange(rows))
    return jnp.transpose(out, (1, 0, 2, 3, 4)).reshape(bsz, seqlen, h * hd)


def hybrid_layer(x, w_in, conv_w, rpb, g_conv, g_attn, w_out, ln_g, ln_b):
    bsz, seqlen, _ = x.shape
    proj = jnp.einsum('bld,dp->blp', x, w_in)
    splits = np.cumsum([CONV_WIDTH] * 4 + [ATTN_WIDTH] * 3)
    xc, bc, cc, zc, q, k, v, za = jnp.split(proj, splits, axis=-1)
    yc = bc * centred_depthwise_conv(cc * xc, conv_w)
    yc = group_rmsnorm(yc, g_conv, CONV_GROUPS) * jax.nn.silu(zc)
    shp = (bsz, seqlen, N_HEADS, HEAD_DIM)
    ya = neighbourhood_attention(q.reshape(shp), k.reshape(shp), v.reshape(shp), rpb)
    ya = group_rmsnorm(ya, g_attn, N_HEADS) * jax.nn.silu(za)
    mix = jnp.concatenate([yc, ya], axis=-1)
    out = jnp.einsum('blm,md->bld', mix, w_out)
    return layer_norm(DN_ALPHA * x + out, ln_g, ln_b)


def setup_inputs(seed: int = 0) -> dict:
    key = jax.random.key(seed)
    ks = jax.random.split(key, 12)
    x_prompt = jax.random.normal(ks[0], (BATCH, SEQ, D_MODEL), jnp.float32)
    x_sample = jax.random.normal(ks[1], (DEC_BATCH, DEC_SEQ, D_MODEL), jnp.float32)
    w_in = jax.random.normal(ks[2], (DEPTH, D_MODEL, PROJ_WIDTH), jnp.float32) * D_MODEL ** -0.5
    conv_w = jax.random.normal(ks[3], (DEPTH, CONV_K, CONV_WIDTH), jnp.float32) * CONV_K ** -0.5
    rpb = jax.random.normal(ks[4], (DEPTH, N_HEADS, 2 * WIN_ROWS - 1, 2 * WIN_COLS - 1), jnp.float32) * 0.02
    g_conv = 1.0 + 0.02 * jax.random.normal(ks[5], (DEPTH, CONV_WIDTH), jnp.float32)
    g_attn = 1.0 + 0.02 * jax.random.normal(ks[6], (DEPTH, ATTN_WIDTH), jnp.float32)
    w_out = jax.random.normal(ks[7], (DEPTH, MIX_WIDTH, D_MODEL), jnp.float32) * (MIX_WIDTH ** -0.5) * DN_BETA
    ln_g = 1.0 + 0.02 * jax.random.normal(ks[8], (DEPTH, D_MODEL), jnp.float32)
    ln_b = 0.02 * jax.random.normal(ks[9], (DEPTH, D_MODEL), jnp.float32)
    return {"x_prompt": x_prompt, "x_sample": x_sample, "w_in": w_in, "conv_w": conv_w, "rpb": rpb,
            "g_conv": g_conv, "g_attn": g_attn, "w_out": w_out, "ln_g": ln_g, "ln_b": ln_b}


def reference(x_prompt, x_sample, w_in, conv_w, rpb, g_conv, g_attn, w_out, ln_g, ln_b):
    y_prompt = x_prompt
    y_sample = x_sample
    for d in range(DEPTH):
        y_prompt = hybrid_layer(y_prompt, w_in[d], conv_w[d], rpb[d], g_conv[d], g_attn[d], w_out[d], ln_g[d], ln_b[d])
        y_sample = hybrid_layer(y_sample, w_in[d], conv_w[d], rpb[d], g_conv[d], g_attn[d], w_out[d], ln_g[d], ln_b[d])
    return (y_prompt, y_sample)
```

```cpp
#include <hip/hip_runtime.h>
#include <cstdio>
#include <cstdint>
namespace pg8 {
#define PG8_LAS __attribute__((address_space(3)))
typedef unsigned short bf16_t;
typedef short bf16x8 __attribute__((ext_vector_type(8)));
typedef float f32x4 __attribute__((ext_vector_type(4)));
typedef unsigned u32x4 __attribute__((ext_vector_type(4)));
constexpr int BM = 256, BK = 64, HALF = 128, HTB = HALF * BK * 2  , STAGE_BYTES = 8 * HTB, NXCD = 8, WGM = 8;

__host__ __device__ __forceinline__ int lds_byte(int r, int c) { const int st = (r >> 4) * 2 + (c >> 5), rr = r & 15, cc = c & 31, ob = rr * 64 + cc * 2; return st * 1024 + (ob ^ (((ob >> 9) & 1) << 5)); }
__host__ __device__ __forceinline__ void stage_rc(int b, int& R, int& C) { const int st = b / 1024, sb = b % 1024, swz = sb ^ (((sb >> 9) & 1) << 5); R = (st >> 1) * 16 + swz / 64; C = (st & 1) * 32 + (swz % 64) / 2; }
__host__ __device__ __forceinline__ int perm32(int rho) { const int n = rho >> 4, i = rho & 15; return 8 * (i >> 2) + 4 * n + (i & 3); }

struct Unit { int pm, pn; };
struct Gemm { const bf16_t* A; const bf16_t* Bt; int M, N, K; };

struct StaticOrder {
    int nM, nN, nwg, G, c;
    __host__ __device__ void init(int M, int N, int G_, int c_) { nM = M / BM; nN = N / BM; nwg = nM * nN; G = G_; c = c_; }
    __host__ __device__ bool next(int i, Unit& u) const {
        const long L = (long)i * G + c; if (L >= nwg) return false;
        int wgid = (int)L; { const int q = nwg / NXCD, r = nwg % NXCD, xcd = wgid % NXCD, off = wgid / NXCD; wgid = (xcd < r ? xcd * (q + 1) : r * (q + 1) + (xcd - r) * q) + off; }
        const int nig = WGM * nN, gid = wgid / nig, fm = gid * WGM, gsz = (nM - fm) < WGM ? (nM - fm) : WGM;
        u.pm = fm + ((wgid % nig) % gsz); u.pn = (wgid % nig) / gsz; return true;
    }
    __device__ __forceinline__ void a_ready(const Unit&) const {}
    __device__ __forceinline__ void done(const Unit&) const {}
};

__device__ __forceinline__ unsigned cvt_pk_bf16(float lo, float hi) { unsigned r; asm volatile("v_cvt_pk_bf16_f32 %0, %1, %2" : "=v"(r) : "v"(lo), "v"(hi)); return r; }

struct EpiG1 {
    static constexpr bool PERM = true, AFTER_DRAIN = false, TR = true;
    bf16_t* CV; bf16_t* QP; bf16_t* KP; bf16_t* ZA;
    __device__ __forceinline__ void operator()(f32x4 (&acc)[2][2][4][2], const Unit& u, int wr, int wc, int fr, int fq) const {
        if (u.pn < 8 || u.pn >= 12) {
            bf16_t* O; int ldc, colt;
            if (u.pn < 8) { O = CV; ldc = 2048; colt = u.pn * BM; } else { O = ZA; ldc = 512; colt = (u.pn - 12) * BM; }
            const int row0 = u.pm * BM + wr * 64 + fr, col0 = colt + wc * 32 + 8 * fq;
#pragma unroll
            for (int ai = 0; ai < 2; ++ai)
#pragma unroll
                for (int m = 0; m < 4; ++m) { bf16_t* rowp = O + (size_t)(row0 + ai * HALF + m * 16) * ldc + col0;
#pragma unroll
                    for (int bj = 0; bj < 2; ++bj) { const f32x4 v0 = acc[ai][bj][m][0], v1 = acc[ai][bj][m][1];
                        u32x4 w; w.x = cvt_pk_bf16(v0[0], v0[1]); w.y = cvt_pk_bf16(v0[2], v0[3]); w.z = cvt_pk_bf16(v1[0], v1[1]); w.w = cvt_pk_bf16(v1[2], v1[3]);
                        *(u32x4*)(rowp + bj * HALF) = w; } }
        } else {
            const bool isq = u.pn < 10; bf16_t* O = isq ? QP : KP; const float sc = isq ? 0.125f : 1.0f;
            const int hb = 4 * (u.pn & 1) + (wc >> 1), ks = wc & 1;
#pragma unroll
            for (int ai = 0; ai < 2; ++ai) { const int R = 4 * u.pm + 2 * ai + wr;
#pragma unroll
                for (int m = 0; m < 4; ++m)
#pragma unroll
                    for (int bj = 0; bj < 2; ++bj) { const f32x4 v0 = acc[ai][bj][m][0] * sc, v1 = acc[ai][bj][m][1] * sc;
                        u32x4 w; w.x = cvt_pk_bf16(v0[0], v0[1]); w.y = cvt_pk_bf16(v0[2], v0[3]); w.z = cvt_pk_bf16(v1[0], v1[1]); w.w = cvt_pk_bf16(v1[2], v1[3]);
                        const size_t off = ((size_t)((R * 8 + hb + 2 * bj) * 4 + m) * 2 + ks) * 512 + (size_t)(fq * 16 + fr) * 8;
                        *(u32x4*)(O + off) = w; } }
        }
    }
};
struct EpiV {
    static constexpr bool PERM = false, AFTER_DRAIN = false, TR = false;
    bf16_t* VP;
    __device__ __forceinline__ void operator()(f32x4 (&acc)[2][2][4][2], const Unit& u, int wr, int wc, int fr, int fq) const {
        const int hb = 4 * u.pn + (wc >> 1), dp = wc & 1;
#pragma unroll
        for (int ai = 0; ai < 2; ++ai) { const int R = 4 * u.pm + 2 * ai + wr;
#pragma unroll
            for (int m = 0; m < 4; ++m)
#pragma unroll
                for (int bj = 0; bj < 2; ++bj) { const f32x4 v0 = acc[ai][bj][m][0], v1 = acc[ai][bj][m][1];
                    u32x4 w; w.x = cvt_pk_bf16(v0[0], v0[1]); w.y = cvt_pk_bf16(v0[2], v0[3]); w.z = cvt_pk_bf16(v1[0], v1[1]); w.w = cvt_pk_bf16(v1[2], v1[3]);
                    const size_t off = ((size_t)((R * 8 + hb + 2 * bj) * 4 + m) * 2 + dp) * 512 + (size_t)(fq * 16 + fr) * 8;
                    *(u32x4*)(VP + off) = w; } }
    }
};
struct EpiRes2 {
    static constexpr bool PERM = false, AFTER_DRAIN = false, TR = true;
    float* C; const float* X0; const float* X1; int ldc; float alpha;
    __device__ __forceinline__ void operator()(f32x4 (&acc)[2][2][4][2], const Unit& u, int wr, int wc, int fr, int fq) const {
        const int row0 = u.pm * BM + wr * 64 + fr, col0 = u.pn * BM + wc * 32 + 4 * fq;
        const float* X = (u.pm < 128) ? X0 : X1 - (size_t)32768 * ldc;
#pragma unroll
        for (int ai = 0; ai < 2; ++ai)
#pragma unroll
            for (int m = 0; m < 4; ++m) { const size_t off = (size_t)(row0 + ai * HALF + m * 16) * ldc + col0;
#pragma unroll
                for (int bj = 0; bj < 2; ++bj)
#pragma unroll
                    for (int n = 0; n < 2; ++n) { const f32x4 xv = *(const f32x4*)(X + off + bj * HALF + n * 16); *(f32x4*)(C + off + bj * HALF + n * 16) = acc[ai][bj][m][n] + xv * alpha; } }
    }
};
template <bool TR> __device__ __forceinline__ f32x4 mma16(const bf16x8 w, const bf16x8 a, const f32x4 c) {
    if constexpr (TR) return __builtin_amdgcn_mfma_f32_16x16x32_bf16(w, a, c, 0, 0, 0); else return __builtin_amdgcn_mfma_f32_16x16x32_bf16(a, w, c, 0, 0, 0); }
template <class Epi, class Sched, bool ALIGN_EPI = false, bool SP2 = false>
__device__ __forceinline__ void gemm_phase(PG8_LAS unsigned char* lds, const Gemm g, const Sched& S, const Epi& E) {
    const int tid = threadIdx.x, wid = __builtin_amdgcn_readfirstlane(tid >> 6), lane = tid & 63, wr = wid >> 2, wc = wid & 3, fr = lane & 15, fq = lane >> 4;
    const int K = g.K, nt = K / BK;
    unsigned voffA[2], voffB[2];
#pragma unroll
    for (int i = 0; i < 2; ++i) { int R, C; stage_rc(tid * 16 + i * 8192, R, C); const int Rb = Epi::PERM ? ((R & ~31) + perm32(R & 31)) : R;
        voffA[i] = (unsigned)(R * K + C) * 2u; voffB[i] = (unsigned)(Rb * K + C) * 2u; }
    const size_t kstep = (size_t)(BK * 2);
    const size_t hstep = (size_t)HALF * K * 2;
    const size_t tstep = 2 * hstep;
    const unsigned ldsw = (unsigned)wid * 1024u;
    const int aoff = lds_byte(wr * 64 + fr, fq * 8), boff = lds_byte(wc * 32 + fr, fq * 8);
#define PG8_SA(b, h) (((b) * 2 + (h)) * HTB)
#define PG8_SB(b, h) ((4 + (b) * 2 + (h)) * HTB)
#define PG8_STAGE(bufoff, gbase, voff) do { _Pragma("unroll") for (int _i = 0; _i < 2; ++_i) \
        __builtin_amdgcn_global_load_lds((const unsigned*)((const char*)(gbase) + (voff)[_i]), (PG8_LAS unsigned*)(lds + (bufoff) + ldsw + _i * 8192), 16, 0, 0); } while (0)
#define PG8_LDA(dst, b, h) do { _Pragma("unroll") for (int m = 0; m < 4; ++m) _Pragma("unroll") for (int k = 0; k < 2; ++k) dst[m][k] = *(const PG8_LAS bf16x8*)(lds + PG8_SA(b, h) + aoff + m * 2048 + k * 1024); } while (0)
#define PG8_LDB(dst, b, h) do { _Pragma("unroll") for (int n = 0; n < 2; ++n) _Pragma("unroll") for (int k = 0; k < 2; ++k) dst[n][k] = *(const PG8_LAS bf16x8*)(lds + PG8_SB(b, h) + boff + n * 2048 + k * 1024); } while (0)
#define PG8_MMA(ai, bj, At, Bt) do { __builtin_amdgcn_s_setprio(1); _Pragma("unroll") for (int m = 0; m < 4; ++m) _Pragma("unroll") for (int n = 0; n < 2; ++n) _Pragma("unroll") for (int k = 0; k < 2; ++k) \
        acc[ai][bj][m][n] = mma16<Epi::TR>(Bt[n][k], At[m][k], acc[ai][bj][m][n]); __builtin_amdgcn_s_setprio(0); } while (0)
#define PG8_WAIT_V(n) asm volatile("s_waitcnt vmcnt(" #n ")" ::: "memory")
#define PG8_WAIT_L(n) asm volatile("s_waitcnt lgkmcnt(" #n ")" ::: "memory")
#define PG8_BAR __builtin_amdgcn_s_barrier()
#define PG8_SCHED __builtin_amdgcn_sched_barrier(0)
    Unit cur, nxt; int ui = 0;
    if (!S.next(0, cur)) return;
    f32x4 acc[2][2][4][2];
#pragma unroll
    for (int a = 0; a < 2; ++a)
#pragma unroll
        for (int b = 0; b < 2; ++b)
#pragma unroll
            for (int m = 0; m < 4; ++m)
#pragma unroll
                for (int n = 0; n < 2; ++n) acc[a][b][m][n] = (f32x4){0.f, 0.f, 0.f, 0.f};
    bf16x8 At[4][2], B0[2][2], B1[2][2];
    const char* cA = (const char*)g.A + (size_t)cur.pm * tstep; const char* cB = (const char*)g.Bt + (size_t)cur.pn * tstep;
    S.a_ready(cur);
    if constexpr (SP2) {
        PG8_STAGE(PG8_SB(0, 0), cB, voffB); PG8_STAGE(PG8_SB(0, 1), cB + hstep, voffB); PG8_STAGE(PG8_SA(0, 0), cA, voffA); PG8_STAGE(PG8_SA(0, 1), cA + hstep, voffA);
        if (wr == 1) PG8_BAR;
        PG8_WAIT_V(2); PG8_BAR;
        PG8_STAGE(PG8_SB(1, 0), cB + kstep, voffB); PG8_STAGE(PG8_SA(1, 0), cA + kstep, voffA); PG8_STAGE(PG8_SB(1, 1), cB + hstep + kstep, voffB);
        PG8_WAIT_V(6); PG8_BAR;
    } else {
        PG8_STAGE(PG8_SB(0, 0), cB, voffB); PG8_STAGE(PG8_SA(0, 0), cA, voffA); PG8_STAGE(PG8_SB(0, 1), cB + hstep, voffB); PG8_STAGE(PG8_SA(0, 1), cA + hstep, voffA);
        if (wr == 1) PG8_BAR;
        PG8_WAIT_V(4); PG8_BAR;
        PG8_STAGE(PG8_SB(1, 0), cB + kstep, voffB); PG8_STAGE(PG8_SA(1, 0), cA + kstep, voffA); PG8_STAGE(PG8_SB(1, 1), cB + hstep + kstep, voffB);
        PG8_WAIT_V(6); PG8_BAR;
    }
    for (;;) {
        const bool has_next = S.next(ui + 1, nxt);
        const char* nA = has_next ? (const char*)g.A + (size_t)nxt.pm * tstep : cA; const char* nB = has_next ? (const char*)g.Bt + (size_t)nxt.pn * tstep : cB;
        for (int t = 0; t < nt; t += 2) {
            const bool last = (t == nt - 2);
            const char* a1 = cA + (size_t)(t + 1) * kstep;
            const char* a2 = last ? nA : cA + (size_t)(t + 2) * kstep; const char* b2 = last ? nB : cB + (size_t)(t + 2) * kstep;
            const char* a3 = a2 + kstep; const char* b3 = b2 + kstep;
            if (last && has_next) S.a_ready(nxt);
            if constexpr (SP2) {
            PG8_LDB(B0, 0, 0); PG8_LDB(B1, 0, 1); PG8_SCHED; PG8_LDA(At, 0, 0); PG8_STAGE(PG8_SA(1, 1), a1 + hstep, voffA);
            PG8_WAIT_V(8); PG8_WAIT_L(0); PG8_BAR; PG8_MMA(0, 0, At, B0); PG8_MMA(0, 1, At, B1); PG8_BAR; PG8_SCHED;
            PG8_LDA(At, 0, 1); PG8_STAGE(PG8_SB(0, 0), b2, voffB); PG8_STAGE(PG8_SB(0, 1), b2 + hstep, voffB); PG8_STAGE(PG8_SA(0, 0), a2, voffA);
            PG8_WAIT_V(8); PG8_WAIT_L(0); PG8_BAR; PG8_MMA(1, 0, At, B0); PG8_MMA(1, 1, At, B1); PG8_BAR; PG8_SCHED;
            PG8_LDB(B0, 1, 0); PG8_LDB(B1, 1, 1); PG8_SCHED; PG8_LDA(At, 1, 0); PG8_STAGE(PG8_SA(0, 1), a2 + hstep, voffA);
            PG8_WAIT_V(8); PG8_WAIT_L(0); PG8_BAR; PG8_MMA(0, 0, At, B0); PG8_MMA(0, 1, At, B1); PG8_BAR; PG8_SCHED;
            PG8_LDA(At, 1, 1); PG8_STAGE(PG8_SB(1, 0), b3, voffB); PG8_STAGE(PG8_SB(1, 1), b3 + hstep, voffB); PG8_STAGE(PG8_SA(1, 0), a3, voffA);
            PG8_WAIT_V(8); PG8_WAIT_L(0); PG8_BAR; PG8_MMA(1, 0, At, B0); PG8_MMA(1, 1, At, B1); PG8_BAR; PG8_SCHED;
            } else {
            PG8_LDB(B0, 0, 0); PG8_SCHED; PG8_LDA(At, 0, 0); PG8_STAGE(PG8_SA(1, 1), a1 + hstep, voffA);
            PG8_WAIT_L(8); PG8_BAR; PG8_WAIT_L(0); PG8_MMA(0, 0, At, B0); PG8_BAR; PG8_SCHED;
            PG8_LDB(B1, 0, 1); PG8_STAGE(PG8_SB(0, 0), b2, voffB);
            PG8_BAR; PG8_WAIT_L(0); PG8_MMA(0, 1, At, B1); PG8_BAR;
            PG8_LDA(At, 0, 1); PG8_STAGE(PG8_SA(0, 0), a2, voffA);
            PG8_BAR; PG8_WAIT_L(0); PG8_MMA(1, 0, At, B0); PG8_BAR; PG8_SCHED;
            PG8_STAGE(PG8_SB(0, 1), b2 + hstep, voffB);
            PG8_WAIT_V(6); PG8_BAR; PG8_MMA(1, 1, At, B1); PG8_BAR;
            PG8_LDB(B0, 1, 0); PG8_SCHED; PG8_LDA(At, 1, 0); PG8_STAGE(PG8_SA(0, 1), a2 + hstep, voffA);
            PG8_WAIT_L(8); PG8_BAR; PG8_WAIT_L(0); PG8_MMA(0, 0, At, B0); PG8_BAR; PG8_SCHED;
            PG8_LDB(B1, 1, 1); PG8_STAGE(PG8_SB(1, 0), b3, voffB);
            PG8_BAR; PG8_WAIT_L(0); PG8_MMA(0, 1, At, B1); PG8_BAR;
            PG8_LDA(At, 1, 1); PG8_STAGE(PG8_SA(1, 0), a3, voffA);
            PG8_BAR; PG8_WAIT_L(0); PG8_MMA(1, 0, At, B0); PG8_BAR; PG8_SCHED;
            PG8_STAGE(PG8_SB(1, 1), b3 + hstep, voffB);
            PG8_WAIT_V(6); PG8_BAR; PG8_MMA(1, 1, At, B1); PG8_BAR;
            }
        }
        if constexpr (ALIGN_EPI) { if (wr == 0) PG8_BAR; }
        if constexpr (!Epi::AFTER_DRAIN) { E(acc, cur, wr, wc, fr, fq); S.done(cur); }
        if (!has_next) break;
#pragma unroll
        for (int a = 0; a < 2; ++a)
#pragma unroll
            for (int b = 0; b < 2; ++b)
#pragma unroll
                for (int m = 0; m < 4; ++m)
#pragma unroll
                    for (int n = 0; n < 2; ++n) acc[a][b][m][n] = (f32x4){0.f, 0.f, 0.f, 0.f};
        cur = nxt; cA = nA; cB = nB; ++ui;
        if constexpr (ALIGN_EPI) { if (wr == 1) PG8_BAR; }
    }
    PG8_WAIT_V(0);
    if constexpr (!ALIGN_EPI) { if (wr == 0) PG8_BAR; }
    PG8_BAR;
    if constexpr (Epi::AFTER_DRAIN) { E.fused(acc, cur, wr, wc, fr, fq, lds, wid, lane); S.done(cur); }
#undef PG8_SA
#undef PG8_SB
#undef PG8_STAGE
#undef PG8_LDA
#undef PG8_LDB
#undef PG8_MMA
#undef PG8_WAIT_V
#undef PG8_WAIT_L
#undef PG8_BAR
#undef PG8_SCHED
}
}

constexpr int D_MODEL = 1024, PROJ = 4096, CONVW = 512, NHEAD = 8, HD = 64, GRID_W = 64;
constexpr int TOK_B = 32768;
constexpr int SEQ_P = 4096, SEQ_S = 16384;
constexpr float NORM_EPS = 1e-5f;
constexpr float DN_ALPHA = 1.189207115002721f;
typedef unsigned short bf16;
typedef unsigned v4u __attribute__((ext_vector_type(4)));
typedef float f32x4 __attribute__((ext_vector_type(4)));

__device__ __forceinline__ unsigned f2bf(float f) { unsigned u = __builtin_bit_cast(unsigned, f); return (u + 0x7fffu + ((u >> 16) & 1u)) >> 16; }
__device__ __forceinline__ unsigned pk2(float lo, float hi) { return f2bf(lo) | (f2bf(hi) << 16); }
__device__ __forceinline__ float bf_lo(unsigned w) { return __builtin_bit_cast(float, w << 16); }
__device__ __forceinline__ float bf_hi(unsigned w) { return __builtin_bit_cast(float, w & 0xffff0000u); }
__device__ __forceinline__ void unpack8(const v4u w, float (&f)[8]) { f[0] = bf_lo(w.x); f[1] = bf_hi(w.x); f[2] = bf_lo(w.y); f[3] = bf_hi(w.y); f[4] = bf_lo(w.z); f[5] = bf_hi(w.z); f[6] = bf_lo(w.w); f[7] = bf_hi(w.w); }
__device__ __forceinline__ float silu(float z) { return z / (1.0f + __expf(-z)); }

__device__ __forceinline__ size_t qk_off(int t, int h, int d) { const int R = t >> 6, c = t & 63; return ((size_t)((R * 8 + h) * 4 + (c >> 4)) * 2 + (d >> 5)) * 512 + (size_t)((((d & 31) >> 3) * 16) + (c & 15)) * 8 + (d & 7); }
__device__ __forceinline__ size_t v_off(int t, int h, int d) { const int R = t >> 6, c = t & 63, kidx = c & 15, dt = d >> 4;
    return ((size_t)((R * 8 + h) * 4 + (c >> 4)) * 2 + (dt >> 1)) * 512 + (size_t)((kidx >> 2) * 16 + (d & 15)) * 8 + (dt & 1) * 4 + (kidx & 3); }
__device__ __forceinline__ void mix_token(const bf16* __restrict__ CV, const bf16* __restrict__ QP, const bf16* __restrict__ KP, const bf16* __restrict__ VP, const bf16* __restrict__ ZA,
                                          const float* __restrict__ conv_w, const float* __restrict__ rpb, const float* __restrict__ g_conv, const float* __restrict__ g_attn,
                                          bf16* __restrict__ mix, int L, int t, int lane) {
    const int tl = t % L;
    const bf16* row = CV + (size_t)t * 2048;
    {
        const int ch = 8 * lane;
        float um[8], u0[8], up[8], a[8], b[8];
        unpack8(*(const v4u*)(row + ch), a); unpack8(*(const v4u*)(row + 1024 + ch), b);
#pragma unroll
        for (int i = 0; i < 8; ++i) u0[i] = a[i] * b[i];
        if (tl > 0) { unpack8(*(const v4u*)(row - 2048 + ch), a); unpack8(*(const v4u*)(row - 2048 + 1024 + ch), b);
#pragma unroll
            for (int i = 0; i < 8; ++i) um[i] = a[i] * b[i]; }
        else {
#pragma unroll
            for (int i = 0; i < 8; ++i) um[i] = 0.f; }
        if (tl < L - 1) { unpack8(*(const v4u*)(row + 2048 + ch), a); unpack8(*(const v4u*)(row + 2048 + 1024 + ch), b);
#pragma unroll
            for (int i = 0; i < 8; ++i) up[i] = a[i] * b[i]; }
        else {
#pragma unroll
            for (int i = 0; i < 8; ++i) up[i] = 0.f; }
        float bc[8], zc[8], y[8]; unpack8(*(const v4u*)(row + 512 + ch), bc); unpack8(*(const v4u*)(row + 1536 + ch), zc);
        float ss = 0.f;
#pragma unroll
        for (int i = 0; i < 8; ++i) { y[i] = bc[i] * (conv_w[ch + i] * um[i] + conv_w[512 + ch + i] * u0[i] + conv_w[1024 + ch + i] * up[i]); ss += y[i] * y[i]; }
        ss += __shfl_xor(ss, 1); ss += __shfl_xor(ss, 2); ss += __shfl_xor(ss, 4);
        const float rinv = 1.0f / sqrtf(ss * (1.0f / 64.0f) + NORM_EPS);
        float o[8];
#pragma unroll
        for (int i = 0; i < 8; ++i) o[i] = y[i] * rinv * g_conv[ch + i] * silu(zc[i]);
        v4u w; w.x = pk2(o[0], o[1]); w.y = pk2(o[2], o[3]); w.z = pk2(o[4], o[5]); w.w = pk2(o[6], o[7]);
        *(v4u*)(mix + (size_t)t * D_MODEL + ch) = w;
    }
    const int rows = L / GRID_W, r = tl / GRID_W, c = tl % GRID_W;
    int rs = r - 4; rs = rs < 0 ? 0 : (rs > rows - 8 ? rows - 8 : rs);
    int cs = c - 8; cs = cs < 0 ? 0 : (cs > GRID_W - 16 ? GRID_W - 16 : cs);
    const int t0 = t - tl;
    for (int h = 0; h < NHEAD; ++h) {
        float q[64];
#pragma unroll
        for (int i = 0; i < 8; ++i) { float f[8]; unpack8(*(const v4u*)(QP + qk_off(t, h, 8 * i)), f);
#pragma unroll
            for (int j = 0; j < 8; ++j) q[8 * i + j] = f[j]; }
        float s[2];
#pragma unroll
        for (int e = 0; e < 2; ++e) {
            const int key = lane + 64 * e, kk = key >> 4, j = key & 15;
            const int kt = t0 + (rs + kk) * GRID_W + cs + j;
            float d = 0.f;
#pragma unroll
            for (int i = 0; i < 8; ++i) { float f[8]; unpack8(*(const v4u*)(KP + qk_off(kt, h, 8 * i)), f);
#pragma unroll
                for (int jj = 0; jj < 8; ++jj) d += q[8 * i + jj] * f[jj]; }
            s[e] = d + rpb[(h * 15 + (rs + kk - r + 7)) * 31 + (cs + j - c + 15)];
        }
        float mx = fmaxf(s[0], s[1]);
#pragma unroll
        for (int o = 1; o < 64; o <<= 1) mx = fmaxf(mx, __shfl_xor(mx, o));
        float p0 = __expf(s[0] - mx), p1 = __expf(s[1] - mx), sum = p0 + p1;
#pragma unroll
        for (int o = 1; o < 64; o <<= 1) sum += __shfl_xor(sum, o);
        float acc = 0.f;
        for (int key = 0; key < 128; ++key) {
            const float p = __shfl(key < 64 ? p0 : p1, key & 63);
            const int kk = key >> 4, j = key & 15;
            const int kt = t0 + (rs + kk) * GRID_W + cs + j;
            const unsigned short vv = VP[v_off(kt, h, lane)];
            acc += p * __builtin_bit_cast(float, (unsigned)vv << 16);
        }
        acc /= sum;
        float ss = acc * acc;
#pragma unroll
        for (int o = 1; o < 64; o <<= 1) ss += __shfl_xor(ss, o);
        const float rinv = 1.0f / sqrtf(ss * (1.0f / 64.0f) + NORM_EPS);
        const float za = __builtin_bit_cast(float, (unsigned)ZA[(size_t)t * 512 + h * 64 + lane] << 16);
        const float o = acc * rinv * g_attn[h * 64 + lane] * silu(za);
        mix[(size_t)t * D_MODEL + 512 + h * 64 + lane] = (bf16)f2bf(o);
    }
}
__device__ __forceinline__ void ln_row(float* __restrict__ y, const float* __restrict__ g, const float* __restrict__ b, int lane) {
    f32x4* p = (f32x4*)y + lane;
    f32x4 v[4]; float s = 0.f;
#pragma unroll
    for (int j = 0; j < 4; ++j) { v[j] = p[64 * j]; s += (v[j].x + v[j].y) + (v[j].z + v[j].w); }
#pragma unroll
    for (int o = 1; o < 64; o <<= 1) s += __shfl_xor(s, o);
    const float mean = s * (1.0f / D_MODEL); float s2 = 0.f;
#pragma unroll
    for (int j = 0; j < 4; ++j) { v[j] = v[j] - mean; s2 += (v[j].x * v[j].x + v[j].y * v[j].y) + (v[j].z * v[j].z + v[j].w * v[j].w); }
#pragma unroll
    for (int o = 1; o < 64; o <<= 1) s2 += __shfl_xor(s2, o);
    const float rstd = 1.0f / sqrtf(s2 * (1.0f / D_MODEL) + NORM_EPS);
#pragma unroll
    for (int j = 0; j < 4; ++j) { const f32x4 gg = ((const f32x4*)g)[lane + 64 * j], bb = ((const f32x4*)b)[lane + 64 * j]; p[64 * j] = v[j] * rstd * gg + bb; }
}

#include <hip/hip_cooperative_groups.h>
namespace cg = cooperative_groups;
#define LAS __attribute__((address_space(3)))
#define LDS_WAIT() asm volatile("s_waitcnt lgkmcnt(0)" ::: "memory")
constexpr int NTOK = 65536;
constexpr size_t MiB = 1u << 20;
constexpr size_t WS_WIN = 0, WS_WOUT = 8 * MiB, WS_CTL = 10 * MiB, WS_XB = 16 * MiB, WS_MIX = 144 * MiB, WS_CV = 272 * MiB, WS_QP = 528 * MiB, WS_KP = 592 * MiB, WS_VP = 656 * MiB, WS_ZA = 720 * MiB, WS_END = 784 * MiB;
constexpr int LDS_BYTES = 147456;

struct Params { const float* x0; const float* x1; const float* w_in; const float* conv_w; const float* rpb; const float* g_conv; const float* g_attn;
                const float* w_out; const float* ln_g; const float* ln_b; float* out; unsigned char* ws; };

template <bool MAP> __device__ __forceinline__ void p0_transpose_item(const float* W, int K, int N, bf16* WT, LAS float* scr, int item, int lane) {
    const int nblk = N / 32, kb = item / nblk, nb = item % nblk, k0 = 64 * kb, n0 = 32 * nb;
#pragma unroll 8
    for (int i = 0; i < 32; ++i) { const int kk = 2 * i + (lane >> 5); scr[kk * 33 + (lane & 31)] = W[(size_t)(k0 + kk) * N + n0 + (lane & 31)]; }
    LDS_WAIT(); asm volatile("" ::: "memory");
    const int c = lane & 7;
    int r0 = n0; if (MAP) r0 = n0 < 3072 ? n0 : (n0 < 3584 ? n0 + 512 : n0 - 512);
#pragma unroll
    for (int j = 0; j < 4; ++j) { const int n = (lane >> 3) + 8 * j; const LAS float* s = scr + (8 * c) * 33 + n;
        v4u o; o.x = pk2(s[0 * 33], s[1 * 33]); o.y = pk2(s[2 * 33], s[3 * 33]); o.z = pk2(s[4 * 33], s[5 * 33]); o.w = pk2(s[6 * 33], s[7 * 33]);
        *(v4u*)(WT + (size_t)(r0 + n) * K + k0 + 8 * c) = o; }
    LDS_WAIT(); asm volatile("" ::: "memory");
}

__global__ void __launch_bounds__(512, 2) mega_fwd(Params p) {
    extern __shared__ __attribute__((aligned(16))) unsigned char lds_raw[];
    LAS unsigned char* lds = (LAS unsigned char*)lds_raw;
    cg::grid_group grid = cg::this_grid();
    const int tid = threadIdx.x, lane = tid & 63, wave = __builtin_amdgcn_readfirstlane(tid >> 6);
    const int G = gridDim.x, gw = blockIdx.x * 8 + wave, NGW = G * 8;
    bf16* WinT = (bf16*)(p.ws + WS_WIN); bf16* WoutT = (bf16*)(p.ws + WS_WOUT); bf16* xb = (bf16*)(p.ws + WS_XB); bf16* mix = (bf16*)(p.ws + WS_MIX);
    bf16* CV = (bf16*)(p.ws + WS_CV); bf16* QP = (bf16*)(p.ws + WS_QP); bf16* KP = (bf16*)(p.ws + WS_KP); bf16* VP = (bf16*)(p.ws + WS_VP); bf16* ZA = (bf16*)(p.ws + WS_ZA);

    {
        LAS float* scr = (LAS float*)(lds + wave * 16384);
        constexpr int I_IN = (D_MODEL / 64) * (PROJ / 32), I_OUT = (D_MODEL / 64) * (D_MODEL / 32);
        for (int it = gw; it < I_IN + I_OUT; it += NGW) {
            if (it < I_IN) p0_transpose_item<true>(p.w_in, D_MODEL, PROJ, WinT, scr, it, lane);
            else p0_transpose_item<false>(p.w_out, D_MODEL, D_MODEL, WoutT, scr, it - I_IN, lane);
        }
        const size_t n4 = (size_t)TOK_B * D_MODEL / 4;
        for (size_t i = (size_t)blockIdx.x * 512 + tid; i < 2 * n4; i += (size_t)G * 512) {
            const f32x4 v = (i < n4) ? ((const f32x4*)p.x0)[i] : ((const f32x4*)p.x1)[i - n4];
            uint2 o; o.x = pk2(v.x, v.y); o.y = pk2(v.z, v.w);
            ((uint2*)xb)[i] = o;
        }
    }
    grid.sync();
    {
        pg8::Gemm g{xb, WinT, NTOK, 3584, D_MODEL}; pg8::StaticOrder S; S.init(NTOK, 3584, G, blockIdx.x);
        pg8::EpiG1 E{CV, QP, KP, ZA};
        pg8::gemm_phase<pg8::EpiG1, pg8::StaticOrder, true, true>(lds, g, S, E);
    }
    {
        pg8::Gemm g{xb, WinT + (size_t)3584 * D_MODEL, NTOK, 512, D_MODEL}; pg8::StaticOrder S; S.init(NTOK, 512, G, blockIdx.x);
        pg8::EpiV E{VP};
        pg8::gemm_phase<pg8::EpiV, pg8::StaticOrder, true, true>(lds, g, S, E);
    }
    grid.sync();
    for (int t = gw; t < NTOK; t += NGW) mix_token(CV, QP, KP, VP, ZA, p.conv_w, p.rpb, p.g_conv, p.g_attn, mix, t < TOK_B ? SEQ_P : SEQ_S, t, lane);
    grid.sync();
    {
        pg8::Gemm g{mix, WoutT, NTOK, D_MODEL, D_MODEL}; pg8::StaticOrder S; S.init(NTOK, D_MODEL, G, blockIdx.x);
        pg8::EpiRes2 E{p.out, p.x0, p.x1, D_MODEL, DN_ALPHA};
        pg8::gemm_phase<pg8::EpiRes2, pg8::StaticOrder, true, true>(lds, g, S, E);
    }
    grid.sync();
    for (int rowi = gw; rowi < NTOK; rowi += NGW) ln_row(p.out + (size_t)rowi * D_MODEL, p.ln_g, p.ln_b, lane);
}

extern "C" void kernel_launch(void* const* d_in, const int* in_sizes, int n_in, void* d_out, int out_size, void* d_ws, size_t ws_size, hipStream_t stream) {
    static int grid_blocks = 0;
    if (!grid_blocks) {
        int dev = 0, cus = 0, per_cu = 0;
        (void)hipGetDevice(&dev);
        (void)hipDeviceGetAttribute(&cus, hipDeviceAttributeMultiprocessorCount, dev);
        (void)hipFuncSetAttribute((const void*)mega_fwd, hipFuncAttributeMaxDynamicSharedMemorySize, LDS_BYTES);
        (void)hipOccupancyMaxActiveBlocksPerMultiprocessor(&per_cu, (const void*)mega_fwd, 512, LDS_BYTES);
        if (per_cu < 1) per_cu = 1;
        grid_blocks = cus * per_cu;
        if (ws_size < WS_END) { fprintf(stderr, "kernel_launch: workspace too small (%zu < %zu)\n", ws_size, (size_t)WS_END); grid_blocks = -1; }
    }
    if (grid_blocks < 0) return;
    Params p{};
    p.x0 = (const float*)d_in[0]; p.x1 = (const float*)d_in[1]; p.w_in = (const float*)d_in[2]; p.conv_w = (const float*)d_in[3]; p.rpb = (const float*)d_in[4];
    p.g_conv = (const float*)d_in[5]; p.g_attn = (const float*)d_in[6]; p.w_out = (const float*)d_in[7]; p.ln_g = (const float*)d_in[8]; p.ln_b = (const float*)d_in[9];
    p.out = (float*)d_out; p.ws = (unsigned char*)d_ws;
    void* args[] = {&p};
    hipError_t e = hipLaunchCooperativeKernel((const void*)mega_fwd, dim3(grid_blocks), dim3(512), args, LDS_BYTES, stream);
    if (e != hipSuccess) fprintf(stderr, "cooperative launch failed: %s (grid %d)\n", hipGetErrorString(e), grid_blocks);
}
```

```cpp
#include <hip/hip_runtime.h>
#include <cstdio>
#include <cstdint>
namespace pg8 {
#define PG8_LAS __attribute__((address_space(3)))
typedef unsigned short bf16_t;
typedef short bf16x8 __attribute__((ext_vector_type(8)));
typedef float f32x4 __attribute__((ext_vector_type(4)));
typedef unsigned u32x4 __attribute__((ext_vector_type(4)));
constexpr int BM = 256, BK = 64, HALF = 128, HTB = HALF * BK * 2  , STAGE_BYTES = 8 * HTB, NXCD = 8, WGM = 8;

__host__ __device__ __forceinline__ int lds_byte(int r, int c) { const int st = (r >> 4) * 2 + (c >> 5), rr = r & 15, cc = c & 31, ob = rr * 64 + cc * 2; return st * 1024 + (ob ^ (((ob >> 9) & 1) << 5)); }
__host__ __device__ __forceinline__ void stage_rc(int b, int& R, int& C) { const int st = b / 1024, sb = b % 1024, swz = sb ^ (((sb >> 9) & 1) << 5); R = (st >> 1) * 16 + swz / 64; C = (st & 1) * 32 + (swz % 64) / 2; }
__host__ __device__ __forceinline__ int perm32(int rho) { const int n = rho >> 4, i = rho & 15; return 8 * (i >> 2) + 4 * n + (i & 3); }

struct Unit { int pm, pn; };
struct Gemm { const bf16_t* A; const bf16_t* Bt; int M, N, K; };

struct StaticOrder {
    int nM, nN, nwg, G, c;
    __host__ __device__ void init(int M, int N, int G_, int c_) { nM = M / BM; nN = N / BM; nwg = nM * nN; G = G_; c = c_; }
    __host__ __device__ bool next(int i, Unit& u) const {
        const long L = (long)i * G + c; if (L >= nwg) return false;
        int wgid = (int)L; { const int q = nwg / NXCD, r = nwg % NXCD, xcd = wgid % NXCD, off = wgid / NXCD; wgid = (xcd < r ? xcd * (q + 1) : r * (q + 1) + (xcd - r) * q) + off; }
        const int nig = WGM * nN, gid = wgid / nig, fm = gid * WGM, gsz = (nM - fm) < WGM ? (nM - fm) : WGM;
        u.pm = fm + ((wgid % nig) % gsz); u.pn = (wgid % nig) / gsz; return true;
    }
    __device__ __forceinline__ void a_ready(const Unit&) const {}
    __device__ __forceinline__ void done(const Unit&) const {}
};

__device__ __forceinline__ unsigned cvt_pk_bf16(float lo, float hi) { unsigned r; asm volatile("v_cvt_pk_bf16_f32 %0, %1, %2" : "=v"(r) : "v"(lo), "v"(hi)); return r; }

struct EpiG1 {
    static constexpr bool PERM = true, AFTER_DRAIN = false, TR = true;
    bf16_t* CV; bf16_t* QP; bf16_t* KP; bf16_t* ZA;
    __device__ __forceinline__ void operator()(f32x4 (&acc)[2][2][4][2], const Unit& u, int wr, int wc, int fr, int fq) const {
        if (u.pn < 8 || u.pn >= 12) {
            bf16_t* O; int ldc, colt;
            if (u.pn < 8) { O = CV; ldc = 2048; colt = u.pn * BM; } else { O = ZA; ldc = 512; colt = (u.pn - 12) * BM; }
            const int row0 = u.pm * BM + wr * 64 + fr, col0 = colt + wc * 32 + 8 * fq;
#pragma unroll
            for (int ai = 0; ai < 2; ++ai)
#pragma unroll
                for (int m = 0; m < 4; ++m) { bf16_t* rowp = O + (size_t)(row0 + ai * HALF + m * 16) * ldc + col0;
#pragma unroll
                    for (int bj = 0; bj < 2; ++bj) { const f32x4 v0 = acc[ai][bj][m][0], v1 = acc[ai][bj][m][1];
                        u32x4 w; w.x = cvt_pk_bf16(v0[0], v0[1]); w.y = cvt_pk_bf16(v0[2], v0[3]); w.z = cvt_pk_bf16(v1[0], v1[1]); w.w = cvt_pk_bf16(v1[2], v1[3]);
                        *(u32x4*)(rowp + bj * HALF) = w; } }
        } else {
            const bool isq = u.pn < 10; bf16_t* O = isq ? QP : KP; const float sc = isq ? 0.125f : 1.0f;
            const int hb = 4 * (u.pn & 1) + (wc >> 1), ks = wc & 1;
#pragma unroll
            for (int ai = 0; ai < 2; ++ai) { const int R = 4 * u.pm + 2 * ai + wr;
#pragma unroll
                for (int m = 0; m < 4; ++m)
#pragma unroll
                    for (int bj = 0; bj < 2; ++bj) { const f32x4 v0 = acc[ai][bj][m][0] * sc, v1 = acc[ai][bj][m][1] * sc;
                        u32x4 w; w.x = cvt_pk_bf16(v0[0], v0[1]); w.y = cvt_pk_bf16(v0[2], v0[3]); w.z = cvt_pk_bf16(v1[0], v1[1]); w.w = cvt_pk_bf16(v1[2], v1[3]);
                        const size_t off = ((size_t)((R * 8 + hb + 2 * bj) * 4 + m) * 2 + ks) * 512 + (size_t)(fq * 16 + fr) * 8;
                        *(u32x4*)(O + off) = w; } }
        }
    }
};
struct EpiV {
    static constexpr bool PERM = false, AFTER_DRAIN = false, TR = false;
    bf16_t* VP;
    __device__ __forceinline__ void operator()(f32x4 (&acc)[2][2][4][2], const Unit& u, int wr, int wc, int fr, int fq) const {
        const int hb = 4 * u.pn + (wc >> 1), dp = wc & 1;
#pragma unroll
        for (int ai = 0; ai < 2; ++ai) { const int R = 4 * u.pm + 2 * ai + wr;
#pragma unroll
            for (int m = 0; m < 4; ++m)
#pragma unroll
                for (int bj = 0; bj < 2; ++bj) { const f32x4 v0 = acc[ai][bj][m][0], v1 = acc[ai][bj][m][1];
                    u32x4 w; w.x = cvt_pk_bf16(v0[0], v0[1]); w.y = cvt_pk_bf16(v0[2], v0[3]); w.z = cvt_pk_bf16(v1[0], v1[1]); w.w = cvt_pk_bf16(v1[2], v1[3]);
                    const size_t off = ((size_t)((R * 8 + hb + 2 * bj) * 4 + m) * 2 + dp) * 512 + (size_t)(fq * 16 + fr) * 8;
                    *(u32x4*)(VP + off) = w; } }
    }
};
struct EpiRes2 {
    static constexpr bool PERM = false, AFTER_DRAIN = false, TR = true;
    float* C; const float* X0; const float* X1; int ldc; float alpha;
    __device__ __forceinline__ void operator()(f32x4 (&acc)[2][2][4][2], const Unit& u, int wr, int wc, int fr, int fq) const {
        const int row0 = u.pm * BM + wr * 64 + fr, col0 = u.pn * BM + wc * 32 + 4 * fq;
        const float* X = (u.pm < 128) ? X0 : X1 - (size_t)32768 * ldc;
#pragma unroll
        for (int ai = 0; ai < 2; ++ai)
#pragma unroll
            for (int m = 0; m < 4; ++m) { const size_t off = (size_t)(row0 + ai * HALF + m * 16) * ldc + col0;
#pragma unroll
                for (int bj = 0; bj < 2; ++bj)
#pragma unroll
                    for (int n = 0; n < 2; ++n) { const f32x4 xv = *(const f32x4*)(X + off + bj * HALF + n * 16); *(f32x4*)(C + off + bj * HALF + n * 16) = acc[ai][bj][m][n] + xv * alpha; } }
    }
};
template <bool TR> __device__ __forceinline__ f32x4 mma16(const bf16x8 w, const bf16x8 a, const f32x4 c) {
    if constexpr (TR) return __builtin_amdgcn_mfma_f32_16x16x32_bf16(w, a, c, 0, 0, 0); else return __builtin_amdgcn_mfma_f32_16x16x32_bf16(a, w, c, 0, 0, 0); }
template <class Epi, class Sched, bool ALIGN_EPI = false, bool SP2 = false>
__device__ __forceinline__ void gemm_phase(PG8_LAS unsigned char* lds, const Gemm g, const Sched& S, const Epi& E) {
    const int tid = threadIdx.x, wid = __builtin_amdgcn_readfirstlane(tid >> 6), lane = tid & 63, wr = wid >> 2, wc = wid & 3, fr = lane & 15, fq = lane >> 4;
    const int K = g.K, nt = K / BK;
    unsigned voffA[2], voffB[2];
#pragma unroll
    for (int i = 0; i < 2; ++i) { int R, C; stage_rc(tid * 16 + i * 8192, R, C); const int Rb = Epi::PERM ? ((R & ~31) + perm32(R & 31)) : R;
        voffA[i] = (unsigned)(R * K + C) * 2u; voffB[i] = (unsigned)(Rb * K + C) * 2u; }
    const size_t kstep = (size_t)(BK * 2);
    const size_t hstep = (size_t)HALF * K * 2;
    const size_t tstep = 2 * hstep;
    const unsigned ldsw = (unsigned)wid * 1024u;
    const int aoff = lds_byte(wr * 64 + fr, fq * 8), boff = lds_byte(wc * 32 + fr, fq * 8);
#define PG8_SA(b, h) (((b) * 2 + (h)) * HTB)
#define PG8_SB(b, h) ((4 + (b) * 2 + (h)) * HTB)
#define PG8_STAGE(bufoff, gbase, voff) do { _Pragma("unroll") for (int _i = 0; _i < 2; ++_i) \
        __builtin_amdgcn_global_load_lds((const unsigned*)((const char*)(gbase) + (voff)[_i]), (PG8_LAS unsigned*)(lds + (bufoff) + ldsw + _i * 8192), 16, 0, 0); } while (0)
#define PG8_LDA(dst, b, h) do { _Pragma("unroll") for (int m = 0; m < 4; ++m) _Pragma("unroll") for (int k = 0; k < 2; ++k) dst[m][k] = *(const PG8_LAS bf16x8*)(lds + PG8_SA(b, h) + aoff + m * 2048 + k * 1024); } while (0)
#define PG8_LDB(dst, b, h) do { _Pragma("unroll") for (int n = 0; n < 2; ++n) _Pragma("unroll") for (int k = 0; k < 2; ++k) dst[n][k] = *(const PG8_LAS bf16x8*)(lds + PG8_SB(b, h) + boff + n * 2048 + k * 1024); } while (0)
#define PG8_MMA(ai, bj, At, Bt) do { __builtin_amdgcn_s_setprio(1); _Pragma("unroll") for (int m = 0; m < 4; ++m) _Pragma("unroll") for (int n = 0; n < 2; ++n) _Pragma("unroll") for (int k = 0; k < 2; ++k) \
        acc[ai][bj][m][n] = mma16<Epi::TR>(Bt[n][k], At[m][k], acc[ai][bj][m][n]); __builtin_amdgcn_s_setprio(0); } while (0)
#define PG8_WAIT_V(n) asm volatile("s_waitcnt vmcnt(" #n ")" ::: "memory")
#define PG8_WAIT_L(n) asm volatile("s_waitcnt lgkmcnt(" #n ")" ::: "memory")
#define PG8_BAR __builtin_amdgcn_s_barrier()
#define PG8_SCHED __builtin_amdgcn_sched_barrier(0)
    Unit cur, nxt; int ui = 0;
    if (!S.next(0, cur)) return;
    f32x4 acc[2][2][4][2];
#pragma unroll
    for (int a = 0; a < 2; ++a)
#pragma unroll
        for (int b = 0; b < 2; ++b)
#pragma unroll
            for (int m = 0; m < 4; ++m)
#pragma unroll
                for (int n = 0; n < 2; ++n) acc[a][b][m][n] = (f32x4){0.f, 0.f, 0.f, 0.f};
    bf16x8 At[4][2], B0[2][2], B1[2][2];
    const char* cA = (const char*)g.A + (size_t)cur.pm * tstep; const char* cB = (const char*)g.Bt + (size_t)cur.pn * tstep;
    S.a_ready(cur);
    if constexpr (SP2) {
        PG8_STAGE(PG8_SB(0, 0), cB, voffB); PG8_STAGE(PG8_SB(0, 1), cB + hstep, voffB); PG8_STAGE(PG8_SA(0, 0), cA, voffA); PG8_STAGE(PG8_SA(0, 1), cA + hstep, voffA);
        if (wr == 1) PG8_BAR;
        PG8_WAIT_V(2); PG8_BAR;
        PG8_STAGE(PG8_SB(1, 0), cB + kstep, voffB); PG8_STAGE(PG8_SA(1, 0), cA + kstep, voffA); PG8_STAGE(PG8_SB(1, 1), cB + hstep + kstep, voffB);
        PG8_WAIT_V(6); PG8_BAR;
    } else {
        PG8_STAGE(PG8_SB(0, 0), cB, voffB); PG8_STAGE(PG8_SA(0, 0), cA, voffA); PG8_STAGE(PG8_SB(0, 1), cB + hstep, voffB); PG8_STAGE(PG8_SA(0, 1), cA + hstep, voffA);
        if (wr == 1) PG8_BAR;
        PG8_WAIT_V(4); PG8_BAR;
        PG8_STAGE(PG8_SB(1, 0), cB + kstep, voffB); PG8_STAGE(PG8_SA(1, 0), cA + kstep, voffA); PG8_STAGE(PG8_SB(1, 1), cB + hstep + kstep, voffB);
        PG8_WAIT_V(6); PG8_BAR;
    }
    for (;;) {
        const bool has_next = S.next(ui + 1, nxt);
        const char* nA = has_next ? (const char*)g.A + (size_t)nxt.pm * tstep : cA; const char* nB = has_next ? (const char*)g.Bt + (size_t)nxt.pn * tstep : cB;
        for (int t = 0; t < nt; t += 2) {
            const bool last = (t == nt - 2);
            const char* a1 = cA + (size_t)(t + 1) * kstep;
            const char* a2 = last ? nA : cA + (size_t)(t + 2) * kstep; const char* b2 = last ? nB : cB + (size_t)(t + 2) * kstep;
            const char* a3 = a2 + kstep; const char* b3 = b2 + kstep;
            if (last && has_next) S.a_ready(nxt);
            if constexpr (SP2) {
            PG8_LDB(B0, 0, 0); PG8_LDB(B1, 0, 1); PG8_SCHED; PG8_LDA(At, 0, 0); PG8_STAGE(PG8_SA(1, 1), a1 + hstep, voffA);
            PG8_WAIT_V(8); PG8_WAIT_L(0); PG8_BAR; PG8_MMA(0, 0, At, B0); PG8_MMA(0, 1, At, B1); PG8_BAR; PG8_SCHED;
            PG8_LDA(At, 0, 1); PG8_STAGE(PG8_SB(0, 0), b2, voffB); PG8_STAGE(PG8_SB(0, 1), b2 + hstep, voffB); PG8_STAGE(PG8_SA(0, 0), a2, voffA);
            PG8_WAIT_V(8); PG8_WAIT_L(0); PG8_BAR; PG8_MMA(1, 0, At, B0); PG8_MMA(1, 1, At, B1); PG8_BAR; PG8_SCHED;
            PG8_LDB(B0, 1, 0); PG8_LDB(B1, 1, 1); PG8_SCHED; PG8_LDA(At, 1, 0); PG8_STAGE(PG8_SA(0, 1), a2 + hstep, voffA);
            PG8_WAIT_V(8); PG8_WAIT_L(0); PG8_BAR; PG8_MMA(0, 0, At, B0); PG8_MMA(0, 1, At, B1); PG8_BAR; PG8_SCHED;
            PG8_LDA(At, 1, 1); PG8_STAGE(PG8_SB(1, 0), b3, voffB); PG8_STAGE(PG8_SB(1, 1), b3 + hstep, voffB); PG8_STAGE(PG8_SA(1, 0), a3, voffA);
            PG8_WAIT_V(8); PG8_WAIT_L(0); PG8_BAR; PG8_MMA(1, 0, At, B0); PG8_MMA(1, 1, At, B1); PG8_BAR; PG8_SCHED;
            } else {
            PG8_LDB(B0, 0, 0); PG8_SCHED; PG8_LDA(At, 0, 0); PG8_STAGE(PG8_SA(1, 1), a1 + hstep, voffA);
            PG8_WAIT_L(8); PG8_BAR; PG8_WAIT_L(0); PG8_MMA(0, 0, At, B0); PG8_BAR; PG8_SCHED;
            PG8_LDB(B1, 0, 1); PG8_STAGE(PG8_SB(0, 0), b2, voffB);
            PG8_BAR; PG8_WAIT_L(0); PG8_MMA(0, 1, At, B1); PG8_BAR;
            PG8_LDA(At, 0, 1); PG8_STAGE(PG8_SA(0, 0), a2, voffA);
            PG8_BAR; PG8_WAIT_L(0); PG8_MMA(1, 0, At, B0); PG8_BAR; PG8_SCHED;
            PG8_STAGE(PG8_SB(0, 1), b2 + hstep, voffB);
            PG8_WAIT_V(6); PG8_BAR; PG8_MMA(1, 1, At, B1); PG8_BAR;
            PG8_LDB(B0, 1, 0); PG8_SCHED; PG8_LDA(At, 1, 0); PG8_STAGE(PG8_SA(0, 1), a2 + hstep, voffA);
            PG8_WAIT_L(8); PG8_BAR; PG8_WAIT_L(0); PG8_MMA(0, 0, At, B0); PG8_BAR; PG8_SCHED;
            PG8_LDB(B1, 1, 1); PG8_STAGE(PG8_SB(1, 0), b3, voffB);
            PG8_BAR; PG8_WAIT_L(0); PG8_MMA(0, 1, At, B1); PG8_BAR;
            PG8_LDA(At, 1, 1); PG8_STAGE(PG8_SA(1, 0), a3, voffA);
            PG8_BAR; PG8_WAIT_L(0); PG8_MMA(1, 0, At, B0); PG8_BAR; PG8_SCHED;
            PG8_STAGE(PG8_SB(1, 1), b3 + hstep, voffB);
            PG8_WAIT_V(6); PG8_BAR; PG8_MMA(1, 1, At, B1); PG8_BAR;
            }
        }
        if constexpr (ALIGN_EPI) { if (wr == 0) PG8_BAR; }
        if constexpr (!Epi::AFTER_DRAIN) { E(acc, cur, wr, wc, fr, fq); S.done(cur); }
        if (!has_next) break;
#pragma unroll
        for (int a = 0; a < 2; ++a)
#pragma unroll
            for (int b = 0; b < 2; ++b)
#pragma unroll
                for (int m = 0; m < 4; ++m)
#pragma unroll
                    for (int n = 0; n < 2; ++n) acc[a][b][m][n] = (f32x4){0.f, 0.f, 0.f, 0.f};
        cur = nxt; cA = nA; cB = nB; ++ui;
        if constexpr (ALIGN_EPI) { if (wr == 1) PG8_BAR; }
    }
    PG8_WAIT_V(0);
    if constexpr (!ALIGN_EPI) { if (wr == 0) PG8_BAR; }
    PG8_BAR;
    if constexpr (Epi::AFTER_DRAIN) { E.fused(acc, cur, wr, wc, fr, fq, lds, wid, lane); S.done(cur); }
#undef PG8_SA
#undef PG8_SB
#undef PG8_STAGE
#undef PG8_LDA
#undef PG8_LDB
#undef PG8_MMA
#undef PG8_WAIT_V
#undef PG8_WAIT_L
#undef PG8_BAR
#undef PG8_SCHED
}
}

constexpr int D_MODEL = 1024, PROJ = 4096, CONVW = 512, NHEAD = 8, HD = 64, GRID_W = 64;
constexpr int TOK_B = 32768;
constexpr int SEQ_P = 4096, SEQ_S = 16384;
constexpr float NORM_EPS = 1e-5f;
constexpr float DN_ALPHA = 1.189207115002721f;
typedef unsigned short bf16;
#define LAS __attribute__((address_space(3)))
typedef unsigned v4u __attribute__((ext_vector_type(4)));
typedef float f32x4 __attribute__((ext_vector_type(4)));

__device__ __forceinline__ unsigned f2bf(float f) { unsigned u = __builtin_bit_cast(unsigned, f); return (u + 0x7fffu + ((u >> 16) & 1u)) >> 16; }
__device__ __forceinline__ unsigned pk2(float lo, float hi) { return f2bf(lo) | (f2bf(hi) << 16); }
__device__ __forceinline__ float bf_lo(unsigned w) { return __builtin_bit_cast(float, w << 16); }
__device__ __forceinline__ float bf_hi(unsigned w) { return __builtin_bit_cast(float, w & 0xffff0000u); }
__device__ __forceinline__ void unpack8(const v4u w, float (&f)[8]) { f[0] = bf_lo(w.x); f[1] = bf_hi(w.x); f[2] = bf_lo(w.y); f[3] = bf_hi(w.y); f[4] = bf_lo(w.z); f[5] = bf_hi(w.z); f[6] = bf_lo(w.w); f[7] = bf_hi(w.w); }
__device__ __forceinline__ float silu(float z) { return z / (1.0f + __expf(-z)); }

__device__ __forceinline__ void ln_row(float* __restrict__ y, const float* __restrict__ g, const float* __restrict__ b, int lane) {
    f32x4* p = (f32x4*)y + lane;
    f32x4 v[4]; float s = 0.f;
#pragma unroll
    for (int j = 0; j < 4; ++j) { v[j] = p[64 * j]; s += (v[j].x + v[j].y) + (v[j].z + v[j].w); }
#pragma unroll
    for (int o = 1; o < 64; o <<= 1) s += __shfl_xor(s, o);
    const float mean = s * (1.0f / D_MODEL); float s2 = 0.f;
#pragma unroll
    for (int j = 0; j < 4; ++j) { v[j] = v[j] - mean; s2 += (v[j].x * v[j].x + v[j].y * v[j].y) + (v[j].z * v[j].z + v[j].w * v[j].w); }
#pragma unroll
    for (int o = 1; o < 64; o <<= 1) s2 += __shfl_xor(s2, o);
    const float rstd = 1.0f / sqrtf(s2 * (1.0f / D_MODEL) + NORM_EPS);
#pragma unroll
    for (int j = 0; j < 4; ++j) { const f32x4 gg = ((const f32x4*)g)[lane + 64 * j], bb = ((const f32x4*)b)[lane + 64 * j]; p[64 * j] = v[j] * rstd * gg + bb; }
}
__device__ __forceinline__ void conv_u(const bf16* __restrict__ row, int ch, float (&u)[8]) {
    float a[8], b[8]; unpack8(*(const v4u*)(row + ch), a); unpack8(*(const v4u*)(row + 1024 + ch), b);
#pragma unroll
    for (int i = 0; i < 8; ++i) u[i] = a[i] * b[i];
}
__device__ __forceinline__ void conv_item(const bf16* __restrict__ CV, const float* __restrict__ conv_w, const float* __restrict__ g_conv, bf16* __restrict__ mix, int item, int lane) {
    const int t0 = item * 8, L = t0 < TOK_B ? SEQ_P : SEQ_S, tl0 = t0 % L, ch = 8 * lane;
    float w0[8], w1[8], w2[8], gc[8];
#pragma unroll
    for (int i = 0; i < 8; ++i) { w0[i] = conv_w[ch + i]; w1[i] = conv_w[512 + ch + i]; w2[i] = conv_w[1024 + ch + i]; gc[i] = g_conv[ch + i]; }
    const bf16* row = CV + (size_t)t0 * 2048;
    float um[8], u0[8], up[8];
    if (tl0 > 0) conv_u(row - 2048, ch, um); else {
#pragma unroll
        for (int i = 0; i < 8; ++i) um[i] = 0.f; }
    conv_u(row, ch, u0);
#pragma unroll
    for (int k = 0; k < 8; ++k) {
        if (tl0 + k < L - 1) conv_u(row + 2048, ch, up); else {
#pragma unroll
            for (int i = 0; i < 8; ++i) up[i] = 0.f; }
        float bc[8], zc[8], y[8]; unpack8(*(const v4u*)(row + 512 + ch), bc); unpack8(*(const v4u*)(row + 1536 + ch), zc);
        float ss = 0.f;
#pragma unroll
        for (int i = 0; i < 8; ++i) { y[i] = bc[i] * (w0[i] * um[i] + w1[i] * u0[i] + w2[i] * up[i]); ss += y[i] * y[i]; }
        ss += __shfl_xor(ss, 1); ss += __shfl_xor(ss, 2); ss += __shfl_xor(ss, 4);
        const float rinv = 1.0f / sqrtf(ss * (1.0f / 64.0f) + NORM_EPS);
        float o[8];
#pragma unroll
        for (int i = 0; i < 8; ++i) o[i] = y[i] * rinv * gc[i] * silu(zc[i]);
        v4u w; w.x = pk2(o[0], o[1]); w.y = pk2(o[2], o[3]); w.z = pk2(o[4], o[5]); w.w = pk2(o[6], o[7]);
        *(v4u*)(mix + (size_t)(t0 + k) * D_MODEL + ch) = w;
#pragma unroll
        for (int i = 0; i < 8; ++i) { um[i] = u0[i]; u0[i] = up[i]; }
        row += 2048;
    }
}

typedef short bf16x8v __attribute__((ext_vector_type(8)));
constexpr int ATT_K_OFF = 0, ATT_V_OFF = 73728, ATT_B_OFF = 147456;
__device__ __forceinline__ int clampi(int v, int lo, int hi) { return v < lo ? lo : (v > hi ? hi : v); }
__device__ __forceinline__ void attn_unit(LAS unsigned char* lds, const bf16* __restrict__ QP, const bf16* __restrict__ KP, const bf16* __restrict__ VP, const bf16* __restrict__ ZA,
                                          const float* __restrict__ rpb, const float* __restrict__ g_attn, bf16* __restrict__ mix, int unit, int tid, int wave, int lane) {
    const int h = unit >> 9, R0 = (unit & 511) * 2;
    int rows, SB; if (R0 < 512) { rows = 64; SB = R0 & ~63; } else { rows = 256; SB = 512 + ((R0 - 512) & ~255); }
    const int r0 = R0 - SB;
    const int B0 = clampi(r0 - 4, 0, rows - 8), B1 = clampi(r0 + 1 - 4, 0, rows - 8) + 8, nb = B1 - B0;
    __syncthreads();
    for (int c = wave; c < nb * 8; c += 8) {
        const size_t goff = ((size_t)((SB + B0 + (c >> 3)) * 8 + h) * 4) * 1024 + (size_t)(c & 7) * 512 + (size_t)lane * 8;
        __builtin_amdgcn_global_load_lds((const unsigned*)(KP + goff), (LAS unsigned*)(lds + ATT_K_OFF + c * 1024), 16, 0, 0);
        __builtin_amdgcn_global_load_lds((const unsigned*)(VP + goff), (LAS unsigned*)(lds + ATT_V_OFF + c * 1024), 16, 0, 0);
    }
    if (tid < 465) ((LAS float*)(lds + ATT_B_OFF))[tid] = rpb[h * 465 + tid];
    const int qr = wave >> 2, j = wave & 3, n = lane & 15, g = lane >> 4;
    const int r = r0 + qr, R = R0 + qr, rs = clampi(r - 4, 0, rows - 8), slot0 = rs - B0;
    const bf16* qp = QP + ((size_t)((R * 8 + h) * 4 + j)) * 1024 + (size_t)lane * 8;
    const bf16x8v qf0 = *(const bf16x8v*)qp, qf1 = *(const bf16x8v*)(qp + 512);
    const int t = R * 64 + 16 * j + n;
    asm volatile("s_waitcnt vmcnt(0)" ::: "memory");
    __syncthreads();
    f32x4 S[8][2];
    {
        const int ko0 = clampi(j - (n >= 8 ? 1 : 0), 0, 3) * 2048 + lane * 16, ko1 = clampi(j + 1 - (n >= 8 ? 1 : 0), 0, 3) * 2048 + lane * 16;
        const LAS unsigned char* kb = lds + ATT_K_OFF + slot0 * 8192;
#pragma unroll
        for (int kk = 0; kk < 8; ++kk) {
            const bf16x8v a00 = *(const LAS bf16x8v*)(kb + kk * 8192 + ko0), a01 = *(const LAS bf16x8v*)(kb + kk * 8192 + ko0 + 1024);
            const bf16x8v a10 = *(const LAS bf16x8v*)(kb + kk * 8192 + ko1), a11 = *(const LAS bf16x8v*)(kb + kk * 8192 + ko1 + 1024);
            f32x4 c0 = {0.f, 0.f, 0.f, 0.f}, c1 = {0.f, 0.f, 0.f, 0.f};
            c0 = __builtin_amdgcn_mfma_f32_16x16x32_bf16(a00, qf0, c0, 0, 0, 0); c0 = __builtin_amdgcn_mfma_f32_16x16x32_bf16(a01, qf1, c0, 0, 0, 0);
            c1 = __builtin_amdgcn_mfma_f32_16x16x32_bf16(a10, qf0, c1, 0, 0, 0); c1 = __builtin_amdgcn_mfma_f32_16x16x32_bf16(a11, qf1, c1, 0, 0, 0);
            S[kk][0] = c0; S[kk][1] = c1;
        }
    }
    {
        const int cq = 16 * j + n, cs = clampi(cq - 8, 0, 48);
        const LAS float* bt = (const LAS float*)(lds + ATT_B_OFF) + (rs - r + 7) * 31;
        float mx = -INFINITY;
#pragma unroll
        for (int xy = 0; xy < 2; ++xy)
#pragma unroll
            for (int i = 0; i < 4; ++i) {
                const int ck = 16 * (j + xy) + 4 * g + i - (g >= 2 ? 16 : 0);
                const bool valid = (ck >= cs) && (ck < cs + 16);
                const int dcl = clampi(ck - cq + 15, 0, 30);
#pragma unroll
                for (int kk = 0; kk < 8; ++kk) { const float s = valid ? S[kk][xy][i] + bt[kk * 31 + dcl] : -INFINITY; S[kk][xy][i] = s; mx = fmaxf(mx, s); }
            }
        mx = fmaxf(mx, __shfl_xor(mx, 16)); mx = fmaxf(mx, __shfl_xor(mx, 32));
        float l = 0.f;
#pragma unroll
        for (int kk = 0; kk < 8; ++kk)
#pragma unroll
            for (int xy = 0; xy < 2; ++xy)
#pragma unroll
                for (int i = 0; i < 4; ++i) { const float pv = __expf(S[kk][xy][i] - mx); S[kk][xy][i] = pv; l += pv; }
        l += __shfl_xor(l, 16); l += __shfl_xor(l, 32);
        const float il = 1.0f / l;
        f32x4 O[4];
#pragma unroll
        for (int dt = 0; dt < 4; ++dt) O[dt] = (f32x4){0.f, 0.f, 0.f, 0.f};
        const int vo0 = clampi(j - (g >= 2 ? 1 : 0), 0, 3) * 2048 + lane * 16, vo1 = clampi(j + 1 - (g >= 2 ? 1 : 0), 0, 3) * 2048 + lane * 16;
        const LAS unsigned char* vb = lds + ATT_V_OFF + slot0 * 8192;
#pragma unroll
        for (int kk = 0; kk < 8; ++kk) {
            v4u pw; pw.x = pg8::cvt_pk_bf16(S[kk][0][0], S[kk][0][1]); pw.y = pg8::cvt_pk_bf16(S[kk][0][2], S[kk][0][3]);
                    pw.z = pg8::cvt_pk_bf16(S[kk][1][0], S[kk][1][1]); pw.w = pg8::cvt_pk_bf16(S[kk][1][2], S[kk][1][3]);
            const bf16x8v pf = __builtin_bit_cast(bf16x8v, pw);
            const v4u a0 = *(const LAS v4u*)(vb + kk * 8192 + vo0), a1 = *(const LAS v4u*)(vb + kk * 8192 + vo0 + 1024);
            const v4u b0 = *(const LAS v4u*)(vb + kk * 8192 + vo1), b1 = *(const LAS v4u*)(vb + kk * 8192 + vo1 + 1024);
            v4u f;
            f.x = a0.x; f.y = a0.y; f.z = b0.x; f.w = b0.y; O[0] = __builtin_amdgcn_mfma_f32_16x16x32_bf16(__builtin_bit_cast(bf16x8v, f), pf, O[0], 0, 0, 0);
            f.x = a0.z; f.y = a0.w; f.z = b0.z; f.w = b0.w; O[1] = __builtin_amdgcn_mfma_f32_16x16x32_bf16(__builtin_bit_cast(bf16x8v, f), pf, O[1], 0, 0, 0);
            f.x = a1.x; f.y = a1.y; f.z = b1.x; f.w = b1.y; O[2] = __builtin_amdgcn_mfma_f32_16x16x32_bf16(__builtin_bit_cast(bf16x8v, f), pf, O[2], 0, 0, 0);
            f.x = a1.z; f.y = a1.w; f.z = b1.z; f.w = b1.w; O[3] = __builtin_amdgcn_mfma_f32_16x16x32_bf16(__builtin_bit_cast(bf16x8v, f), pf, O[3], 0, 0, 0);
        }
        float ss = 0.f;
#pragma unroll
        for (int dt = 0; dt < 4; ++dt) { O[dt] = O[dt] * il; ss += (O[dt][0] * O[dt][0] + O[dt][1] * O[dt][1]) + (O[dt][2] * O[dt][2] + O[dt][3] * O[dt][3]); }
        ss += __shfl_xor(ss, 16); ss += __shfl_xor(ss, 32);
        const float rinv = 1.0f / sqrtf(ss * (1.0f / 64.0f) + NORM_EPS);
#pragma unroll
        for (int dt = 0; dt < 4; ++dt) {
            const int d0 = h * 64 + 16 * dt + 4 * g;
            const uint2 zw = *(const uint2*)(ZA + (size_t)t * 512 + d0);
            const f32x4 ga = *(const f32x4*)(g_attn + d0);
            const float o0 = O[dt][0] * rinv * ga[0] * silu(bf_lo(zw.x)), o1 = O[dt][1] * rinv * ga[1] * silu(bf_hi(zw.x));
            const float o2 = O[dt][2] * rinv * ga[2] * silu(bf_lo(zw.y)), o3 = O[dt][3] * rinv * ga[3] * silu(bf_hi(zw.y));
            uint2 w; w.x = pk2(o0, o1); w.y = pk2(o2, o3);
            *(uint2*)(mix + (size_t)t * D_MODEL + 512 + d0) = w;
        }
    }
}

#include <hip/hip_cooperative_groups.h>
namespace cg = cooperative_groups;
#define LAS __attribute__((address_space(3)))
#define LDS_WAIT() asm volatile("s_waitcnt lgkmcnt(0)" ::: "memory")
constexpr int NTOK = 65536;
constexpr size_t MiB = 1u << 20;
constexpr size_t WS_WIN = 0, WS_WOUT = 8 * MiB, WS_CTL = 10 * MiB, WS_XB = 16 * MiB, WS_MIX = 144 * MiB, WS_CV = 272 * MiB, WS_QP = 528 * MiB, WS_KP = 592 * MiB, WS_VP = 656 * MiB, WS_ZA = 720 * MiB, WS_END = 784 * MiB;
constexpr int LDS_BYTES = 155648;

struct Params { const float* x0; const float* x1; const float* w_in; const float* conv_w; const float* rpb; const float* g_conv; const float* g_attn;
                const float* w_out; const float* ln_g; const float* ln_b; float* out; unsigned char* ws; };

template <bool MAP> __device__ __forceinline__ void p0_transpose_item(const float* W, int K, int N, bf16* WT, LAS float* scr, int item, int lane) {
    const int nblk = N / 32, kb = item / nblk, nb = item % nblk, k0 = 64 * kb, n0 = 32 * nb;
#pragma unroll 8
    for (int i = 0; i < 32; ++i) { const int kk = 2 * i + (lane >> 5); scr[kk * 33 + (lane & 31)] = W[(size_t)(k0 + kk) * N + n0 + (lane & 31)]; }
    LDS_WAIT(); asm volatile("" ::: "memory");
    const int c = lane & 7;
    int r0 = n0; if (MAP) r0 = n0 < 3072 ? n0 : (n0 < 3584 ? n0 + 512 : n0 - 512);
#pragma unroll
    for (int j = 0; j < 4; ++j) { const int n = (lane >> 3) + 8 * j; const LAS float* s = scr + (8 * c) * 33 + n;
        v4u o; o.x = pk2(s[0 * 33], s[1 * 33]); o.y = pk2(s[2 * 33], s[3 * 33]); o.z = pk2(s[4 * 33], s[5 * 33]); o.w = pk2(s[6 * 33], s[7 * 33]);
        *(v4u*)(WT + (size_t)(r0 + n) * K + k0 + 8 * c) = o; }
    LDS_WAIT(); asm volatile("" ::: "memory");
}

__global__ void __launch_bounds__(512, 2) mega_fwd(Params p) {
    extern __shared__ __attribute__((aligned(16))) unsigned char lds_raw[];
    LAS unsigned char* lds = (LAS unsigned char*)lds_raw;
    cg::grid_group grid = cg::this_grid();
    const int tid = threadIdx.x, lane = tid & 63, wave = __builtin_amdgcn_readfirstlane(tid >> 6);
    const int G = gridDim.x, gw = blockIdx.x * 8 + wave, NGW = G * 8;
    bf16* WinT = (bf16*)(p.ws + WS_WIN); bf16* WoutT = (bf16*)(p.ws + WS_WOUT); bf16* xb = (bf16*)(p.ws + WS_XB); bf16* mix = (bf16*)(p.ws + WS_MIX);
    bf16* CV = (bf16*)(p.ws + WS_CV); bf16* QP = (bf16*)(p.ws + WS_QP); bf16* KP = (bf16*)(p.ws + WS_KP); bf16* VP = (bf16*)(p.ws + WS_VP); bf16* ZA = (bf16*)(p.ws + WS_ZA);

    {
        LAS float* scr = (LAS float*)(lds + wave * 16384);
        constexpr int I_IN = (D_MODEL / 64) * (PROJ / 32), I_OUT = (D_MODEL / 64) * (D_MODEL / 32);
        for (int it = gw; it < I_IN + I_OUT; it += NGW) {
            if (it < I_IN) p0_transpose_item<true>(p.w_in, D_MODEL, PROJ, WinT, scr, it, lane);
            else p0_transpose_item<false>(p.w_out, D_MODEL, D_MODEL, WoutT, scr, it - I_IN, lane);
        }
        const size_t n4 = (size_t)TOK_B * D_MODEL / 4;
        for (size_t i = (size_t)blockIdx.x * 512 + tid; i < 2 * n4; i += (size_t)G * 512) {
            const f32x4 v = (i < n4) ? ((const f32x4*)p.x0)[i] : ((const f32x4*)p.x1)[i - n4];
            uint2 o; o.x = pk2(v.x, v.y); o.y = pk2(v.z, v.w);
            ((uint2*)xb)[i] = o;
        }
    }
    grid.sync();
    {
        pg8::Gemm g{xb, WinT, NTOK, 3584, D_MODEL}; pg8::StaticOrder S; S.init(NTOK, 3584, G, blockIdx.x);
        pg8::EpiG1 E{CV, QP, KP, ZA};
        pg8::gemm_phase<pg8::EpiG1, pg8::StaticOrder, true, true>(lds, g, S, E);
    }
    {
        pg8::Gemm g{xb, WinT + (size_t)3584 * D_MODEL, NTOK, 512, D_MODEL}; pg8::StaticOrder S; S.init(NTOK, 512, G, blockIdx.x);
        pg8::EpiV E{VP};
        pg8::gemm_phase<pg8::EpiV, pg8::StaticOrder, true, true>(lds, g, S, E);
    }
    grid.sync();
    {
        const int vcu = (G % 8 == 0) ? (blockIdx.x % 8) * (G / 8) + blockIdx.x / 8 : blockIdx.x;
        for (int it = gw; it < NTOK / 8; it += NGW) conv_item(CV, p.conv_w, p.g_conv, mix, it, lane);
        for (int u = vcu; u < 4096; u += G) attn_unit(lds, QP, KP, VP, ZA, p.rpb, p.g_attn, mix, u, tid, wave, lane);
    }
    grid.sync();
    {
        pg8::Gemm g{mix, WoutT, NTOK, D_MODEL, D_MODEL}; pg8::StaticOrder S; S.init(NTOK, D_MODEL, G, blockIdx.x);
        pg8::EpiRes2 E{p.out, p.x0, p.x1, D_MODEL, DN_ALPHA};
        pg8::gemm_phase<pg8::EpiRes2, pg8::StaticOrder, true, true>(lds, g, S, E);
    }
    grid.sync();
    for (int rowi = gw; rowi < NTOK; rowi += NGW) ln_row(p.out + (size_t)rowi * D_MODEL, p.ln_g, p.ln_b, lane);
}

extern "C" void kernel_launch(void* const* d_in, const int* in_sizes, int n_in, void* d_out, int out_size, void* d_ws, size_t ws_size, hipStream_t stream) {
    static int grid_blocks = 0;
    if (!grid_blocks) {
        int dev = 0, cus = 0, per_cu = 0;
        (void)hipGetDevice(&dev);
        (void)hipDeviceGetAttribute(&cus, hipDeviceAttributeMultiprocessorCount, dev);
        (void)hipFuncSetAttribute((const void*)mega_fwd, hipFuncAttributeMaxDynamicSharedMemorySize, LDS_BYTES);
        (void)hipOccupancyMaxActiveBlocksPerMultiprocessor(&per_cu, (const void*)mega_fwd, 512, LDS_BYTES);
        if (per_cu < 1) per_cu = 1;
        grid_blocks = cus * per_cu;
        if (ws_size < WS_END) { fprintf(stderr, "kernel_launch: workspace too small (%zu < %zu)\n", ws_size, (size_t)WS_END); grid_blocks = -1; }
    }
    if (grid_blocks < 0) return;
    Params p{};
    p.x0 = (const float*)d_in[0]; p.x1 = (const float*)d_in[1]; p.w_in = (const float*)d_in[2]; p.conv_w = (const float*)d_in[3]; p.rpb = (const float*)d_in[4];
    p.g_conv = (const float*)d_in[5]; p.g_attn = (const float*)d_in[6]; p.w_out = (const float*)d_in[7]; p.ln_g = (const float*)d_in[8]; p.ln_b = (const float*)d_in[9];
    p.out = (float*)d_out; p.ws = (unsigned char*)d_ws;
    void* args[] = {&p};
    hipError_t e = hipLaunchCooperativeKernel((const void*)mega_fwd, dim3(grid_blocks), dim3(512), args, LDS_BYTES, stream);
    if (e != hipSuccess) fprintf(stderr, "cooperative launch failed: %s (grid %d)\n", hipGetErrorString(e), grid_blocks);
}
```
